# Optimizing an MI355X kernel written in HIP

```python
import math
import jax, jax.numpy as jnp
from jax import lax
import numpy as np

D_MODEL = 1024
BATCH = 8
SEQ = 2048
DEPTH = 1
DEC_BATCH = 128
DEC_SEQ = 4
PAST_LEN = 16384
PAGE_SIZE = 128

D_MIX = D_MODEL
HEAD_DIM = 64
D_ATTN = D_MIX // 2
N_HEADS = D_ATTN // HEAD_DIM
N_KV_HEADS = 2
N_REP = N_HEADS // N_KV_HEADS
D_KV = N_KV_HEADS * HEAD_DIM
D_SSM = D_MIX - D_ATTN
SSM_GROUP = 16
N_SSM_GROUPS = D_SSM // SSM_GROUP
SSM_STATE = 64
WINDOW = 128
BLOCK = WINDOW
NUM_BUCKETS = 32
MAX_DISTANCE = 128
D_FF = 2816
D_IN = D_ATTN + 2 * D_KV + D_SSM
RMS_EPS = 1e-6
NEG_INF = -1e30
DT_MIN = 0.001
DT_MAX = 0.1

kernel_name = 'hymba_swa_sink_s5_macaron_step'


def rmsnorm(x, g):
    xf = x.astype(jnp.float32)
    r = lax.rsqrt(jnp.mean(xf * xf, axis=-1, keepdims=True) + RMS_EPS)
    return (xf * r).astype(x.dtype) * g


def macaron_half_ffn(x, g, wg, wu, wd):
    h = rmsnorm(x, g)
    return x + 0.5 * ((jax.nn.silu(h @ wg) * (h @ wu)) @ wd)


def t5_bucket(d):
    d = jnp.maximum(d, 0)
    max_exact = NUM_BUCKETS // 2
    df = jnp.maximum(d, 1).astype(jnp.float32)
    large = max_exact + (jnp.log(df / max_exact) / math.log(MAX_DISTANCE / max_exact)
                         * (NUM_BUCKETS - max_exact)).astype(jnp.int32)
    large = jnp.minimum(large, NUM_BUCKETS - 1)
    return jnp.where(d < max_exact, d, large)


def rel_bias_for(d, rel_bias):
    b = rel_bias[t5_bucket(d)].astype(jnp.float32)
    return jnp.transpose(b, (2, 0, 1)).reshape(N_KV_HEADS, N_REP, d.shape[0], d.shape[1])


def sink_probs(logits, sinks):
    s = sinks.astype(jnp.float32).reshape(N_KV_HEADS, N_REP)[:, :, None, None]
    m = jnp.maximum(jnp.max(logits, axis=-1, keepdims=True), s)
    e = jnp.exp(logits - m)
    return e / (jnp.sum(e, axis=-1, keepdims=True) + jnp.exp(s - m))


def split_projection(h, w_in):
    b, l = h.shape[:2]
    p = h @ w_in
    q = p[..., :D_ATTN].reshape(b, l, N_HEADS, HEAD_DIM)
    o = D_ATTN
    k = p[..., o:o + D_KV].reshape(b, l, N_KV_HEADS, HEAD_DIM)
    o += D_KV
    v = p[..., o:o + D_KV].reshape(b, l, N_KV_HEADS, HEAD_DIM)
    o += D_KV
    u = p[..., o:]
    return q, k, v, u


def swa_prompt(q, k, v, rel_bias, sinks):
    b, l = q.shape[:2]
    nb = l // BLOCK
    qb = q.reshape(b, nb, BLOCK, N_KV_HEADS, N_REP, HEAD_DIM)

    def band(t):
        cur = t.reshape(b, nb, BLOCK, N_KV_HEADS, HEAD_DIM)
        prev = jnp.concatenate([jnp.zeros_like(cur[:, :1]), cur[:, :-1]], axis=1)
        return jnp.concatenate([prev, cur], axis=2)

    kb, vb = band(k), band(v)
    logits = jnp.einsum('bnqgrd,bnkgd->bngrqk', qb, kb).astype(jnp.float32) * (HEAD_DIM ** -0.5)
    qi = jnp.arange(BLOCK)[:, None]
    kj = jnp.arange(2 * BLOCK)[None, :]
    d = qi - kj + BLOCK
    blk = jnp.arange(nb)[:, None, None]
    valid = (d >= 0) & (d < WINDOW) & ((blk > 0) | (kj >= BLOCK))
    logits = logits + rel_bias_for(d, rel_bias)
    logits = jnp.where(valid[:, None, None], logits, NEG_INF)
    p = sink_probs(logits, sinks)
    out = jnp.einsum('bngrqk,bnkgd->bnqgrd', p.astype(vb.dtype), vb)
    return out.reshape(b, l, D_ATTN)


def swa_sample(q, k_new, v_new, cache_k, cache_v, rel_bias, sinks):
    db, t = q.shape[:2]
    w = cache_k.shape[1]
    k_all = jnp.concatenate([cache_k.astype(k_new.dtype), k_new], axis=1)
    v_all = jnp.concatenate([cache_v.astype(v_new.dtype), v_new], axis=1)
    d = jnp.arange(t)[:, None] - jnp.arange(w + t)[None, :] + w
    valid = (d >= 0) & (d < WINDOW)
    qg = q.reshape(db, t, N_KV_HEADS, N_REP, HEAD_DIM)
    logits = jnp.einsum('bqgrd,bkgd->bgrqk', qg, k_all).astype(jnp.float32) * (HEAD_DIM ** -0.5)
    logits = logits + rel_bias_for(d, rel_bias)
    logits = jnp.where(valid, logits, NEG_INF)
    p = sink_probs(logits, sinks)
    out = jnp.einsum('bgrqk,bkgd->bqgrd', p.astype(v_all.dtype), v_all).reshape(db, t, D_ATTN)
    return out, k_all[:, t:], v_all[:, t:]


def s5_block(u, x0, log_dt, a_re, a_im, b_re, b_im, c_re, c_im, d_skip, w_glu, b_glu):
    f32 = jnp.float32
    bsz, l = u.shape[:2]
    uf = u.astype(f32)
    ug = uf.reshape(bsz, l, N_SSM_GROUPS, SSM_GROUP)
    lam = lax.complex(a_re.astype(f32), a_im.astype(f32))
    dt = jnp.exp(log_dt.astype(f32))[:, None]
    lam_bar = jnp.exp(lam * dt)
    b_mat = lax.complex(b_re.astype(f32), b_im.astype(f32))
    b_bar = ((lam_bar - 1.0) / lam)[..., None] * b_mat
    bu = jnp.einsum('blgc,gpc->blgp', ug.astype(jnp.complex64), b_bar)
    bu = bu.at[:, 0].add(lam_bar * x0)
    a = jnp.broadcast_to(lam_bar, bu.shape)

    def combine(e1, e2):
        a1, b1 = e1
        a2, b2 = e2
        return a1 * a2, a2 * b1 + b2

    _, xs = lax.associative_scan(combine, (a, bu), axis=1)
    c_mat = lax.complex(c_re.astype(f32), c_im.astype(f32))
    y = jnp.real(jnp.einsum('gcp,blgp->blgc', c_mat, xs)).reshape(bsz, l, D_SSM)
    y = y + d_skip.astype(f32) * uf
    y = jax.nn.gelu(y)
    y = y * jax.nn.sigmoid(y @ w_glu.astype(f32) + b_glu.astype(f32))
    x_last = xs[:, -1]
    return y.astype(u.dtype), jnp.real(x_last), jnp.imag(x_last)


def setup_inputs(seed: int = 0) -> dict:
    key = jax.random.key(seed)
    ks = iter(jax.random.split(key, 40))
    f32 = jnp.float32

    def nrm(shape, scale):
        return jax.random.normal(next(ks), shape, f32) * scale

    w_buf = min(WINDOW, PAST_LEN)
    L, G, P, C = DEPTH, N_SSM_GROUPS, SSM_STATE, SSM_GROUP
    inp = {}
    inp['x_prompt'] = nrm((BATCH, SEQ, D_MODEL), 1.0)
    inp['x_sample'] = nrm((DEC_BATCH, DEC_SEQ, D_MODEL), 1.0)
    inp['cache_k'] = nrm((L, DEC_BATCH, w_buf, N_KV_HEADS, HEAD_DIM), 1.0)
    inp['cache_v'] = nrm((L, DEC_BATCH, w_buf, N_KV_HEADS, HEAD_DIM), 1.0)
    inp['state_ssm_re'] = nrm((L, DEC_BATCH, G, P), 0.3)
    inp['state_ssm_im'] = nrm((L, DEC_BATCH, G, P), 0.3)
    inp['rel_bias'] = nrm((NUM_BUCKETS, N_HEADS), 0.5)
    inp['ffn1_norm'] = 1.0 + nrm((L, D_MODEL), 0.01)
    inp['ffn1_w_gate'] = nrm((L, D_MODEL, D_FF), D_MODEL ** -0.5)
    inp['ffn1_w_up'] = nrm((L, D_MODEL, D_FF), D_MODEL ** -0.5)
    inp['ffn1_w_down'] = nrm((L, D_FF, D_MODEL), D_FF ** -0.5)
    inp['mix_norm'] = 1.0 + nrm((L, D_MODEL), 0.01)
    inp['w_in'] = nrm((L, D_MODEL, D_IN), D_MODEL ** -0.5)
    inp['sinks'] = nrm((L, N_HEADS), 0.5)
    inp['log_dt'] = jax.random.uniform(next(ks), (L, G), f32, math.log(DT_MIN), math.log(DT_MAX))
    inp['a_re'] = -0.5 + nrm((L, G, P), 0.01)
    inp['a_im'] = math.pi * jnp.arange(P, dtype=f32) + nrm((L, G, P), 0.01)
    inp['b_re'] = nrm((L, G, P, C), (2.0 * C) ** -0.5)
    inp['b_im'] = nrm((L, G, P, C), (2.0 * C) ** -0.5)
    inp['c_re'] = nrm((L, G, C, P), (2.0 * P) ** -0.5)
    inp['c_im'] = nrm((L, G, C, P), (2.0 * P) ** -0.5)
    inp['d_skip'] = nrm((L, D_SSM), 0.5)
    inp['w_glu'] = nrm((L, D_SSM, D_SSM), D_SSM ** -0.5)
    inp['b_glu'] = nrm((L, D_SSM), 0.01)
    inp['w_out'] = nrm((L, D_MIX, D_MODEL), D_MIX ** -0.5)
    inp['ffn2_norm'] = 1.0 + nrm((L, D_MODEL), 0.01)
    inp['ffn2_w_gate'] = nrm((L, D_MODEL, D_FF), D_MODEL ** -0.5)
    inp['ffn2_w_up'] = nrm((L, D_MODEL, D_FF), D_MODEL ** -0.5)
    inp['ffn2_w_down'] = nrm((L, D_FF, D_MODEL), D_FF ** -0.5)
    inp['final_norm'] = 1.0 + nrm((D_MODEL,), 0.01)
    return inp


def reference(x_prompt, x_sample, cache_k, cache_v, state_ssm_re, state_ssm_im, rel_bias,
              ffn1_norm, ffn1_w_gate, ffn1_w_up, ffn1_w_down, mix_norm, w_in, sinks,
              log_dt, a_re, a_im, b_re, b_im, c_re, c_im, d_skip, w_glu, b_glu, w_out,
              ffn2_norm, ffn2_w_gate, ffn2_w_up, ffn2_w_down, final_norm):
    y_p, y_s = x_prompt, x_sample
    k_p_l, v_p_l, re_p_l, im_p_l = [], [], [], []
    k_s_l, v_s_l, re_s_l, im_s_l = [], [], [], []
    for i in range(DEPTH):
        ffn1 = (ffn1_norm[i], ffn1_w_gate[i], ffn1_w_up[i], ffn1_w_down[i])
        ffn2 = (ffn2_norm[i], ffn2_w_gate[i], ffn2_w_up[i], ffn2_w_down[i])
        ssm_w = (log_dt[i], a_re[i], a_im[i], b_re[i], b_im[i], c_re[i], c_im[i],
                 d_skip[i], w_glu[i], b_glu[i])

        y_p = macaron_half_ffn(y_p, *ffn1)
        q, k, v, u = split_projection(rmsnorm(y_p, mix_norm[i]), w_in[i])
        attn = swa_prompt(q, k, v, rel_bias, sinks[i])
        x0 = jnp.zeros((y_p.shape[0], N_SSM_GROUPS, SSM_STATE), jnp.complex64)
        ssm, s_re, s_im = s5_block(u, x0, *ssm_w)
        y_p = y_p + jnp.concatenate([attn, ssm], axis=-1) @ w_out[i]
        y_p = macaron_half_ffn(y_p, *ffn2)
        w_p = min(WINDOW, k.shape[1])
        k_p_l.append(k[:, k.shape[1] - w_p:])
        v_p_l.append(v[:, v.shape[1] - w_p:])
        re_p_l.append(s_re)
        im_p_l.append(s_im)

        y_s = macaron_half_ffn(y_s, *ffn1)
        q, k, v, u = split_projection(rmsnorm(y_s, mix_norm[i]), w_in[i])
        attn, k_buf, v_buf = swa_sample(q, k, v, cache_k[i], cache_v[i], rel_bias, sinks[i])
        x0 = lax.complex(state_ssm_re[i].astype(jnp.float32), state_ssm_im[i].astype(jnp.float32))
        ssm, s_re, s_im = s5_block(u, x0, *ssm_w)
        y_s = y_s + jnp.concatenate([attn, ssm], axis=-1) @ w_out[i]
        y_s = macaron_half_ffn(y_s, *ffn2)
        k_s_l.append(k_buf)
        v_s_l.append(v_buf)
        re_s_l.append(s_re)
        im_s_l.append(s_im)

    y_prompt = rmsnorm(y_p, final_norm)
    y_sample = rmsnorm(y_s, final_norm)
    return (y_prompt, y_sample,
            jnp.stack(k_p_l), jnp.stack(v_p_l), jnp.stack(re_p_l), jnp.stack(im_p_l),
            jnp.stack(k_s_l), jnp.stack(v_s_l), jnp.stack(re_s_l), jnp.stack(im_s_l))
```

```cpp
#include <hip/hip_runtime.h>
#include <cstdio>
#include <cstdint>

#define LAS __attribute__((address_space(3)))
#define GAS __attribute__((address_space(1)))
typedef _Float16 f16;
typedef _Float16 h8 __attribute__((ext_vector_type(8)));
typedef _Float16 h4 __attribute__((ext_vector_type(4)));
typedef _Float16 h2 __attribute__((ext_vector_type(2)));
typedef float f32x4 __attribute__((ext_vector_type(4)));
typedef float f32x2 __attribute__((ext_vector_type(2)));
typedef unsigned u32x4 __attribute__((ext_vector_type(4)));
typedef unsigned u32x2 __attribute__((ext_vector_type(2)));
typedef short v4i16_t __attribute__((ext_vector_type(4)));

constexpr int DM = 1024, DFF = 2816, DIN = 1280, DATT = 512, DSSM = 512, NHEAD = 8, HD = 64, NG = 32, SP = 64, SC = 16;
constexpr int BATCH = 8, SEQ = 2048, DBATCH = 128, DSEQ = 4, WBUF = 128;
constexpr int MP = BATCH * SEQ, MS = DBATCH * DSEQ, M = MP + MS;
constexpr float RMS_EPS = 1e-6f;
constexpr float LOG2E = 1.4426950408889634f;
constexpr float QSCALE = 0.125f * LOG2E;

constexpr size_t OUT_Y = 0, OUT_KP = (size_t)M * DM, OUT_VP = OUT_KP + 131072, OUT_SRP = OUT_VP + 131072, OUT_SIP = OUT_SRP + 16384,
                 OUT_KS = OUT_SIP + 16384, OUT_VS = OUT_KS + 2097152, OUT_SRS = OUT_VS + 2097152, OUT_SIS = OUT_SRS + 262144, OUT_END = OUT_SIS + 262144;

constexpr size_t MiB = 1u << 20;
constexpr size_t WS_CTL = 0, CTL_ZERO_BYTES = 65536;
constexpr size_t WS_W1A = 1 * MiB, WS_W1D = 12 * MiB, WS_WIN = 18 * MiB, WS_WGLU = 21 * MiB, WS_WOUT = 22 * MiB, WS_W2A = 24 * MiB, WS_W2D = 35 * MiB;
constexpr size_t WS_SSM = 41 * MiB, SSM_STRIDE = 160 * 1024;
constexpr size_t SSM_W2 = 0, SSM_W3 = 65536, SSM_KG = 131072, SSM_CONST = 139264;
constexpr size_t WS_SSQ1 = 46 * MiB, WS_SSQ2 = 47 * MiB + 512 * 1024, WS_SSQ3 = 49 * MiB;
constexpr size_t WS_TB = 51 * MiB;
constexpr size_t WS_XH = 53 * MiB;
constexpr size_t WS_XR = 86 * MiB;
constexpr size_t WS_ACT = 152 * MiB;
constexpr size_t WS_MIX = 152 * MiB, WS_KH = 185 * MiB, WS_VH = 190 * MiB, WS_UH = 195 * MiB, WS_YG = 212 * MiB;
constexpr size_t WS_END = 243 * MiB;
static_assert(WS_SSM + NG * SSM_STRIDE <= WS_SSQ1 && WS_YG + (size_t)M * 512 * 2 <= WS_END && WS_ACT + (size_t)M * DFF * 2 <= WS_END, "ws map");

constexpr int CW_BAR = 1024;

constexpr int RING_BYTES = 131072;
constexpr int LDSCTL_OFF = 152 * 1024, MISC_OFF = LDSCTL_OFF + 320;
constexpr int LDS_BYTES = 156 * 1024;
constexpr int NWAVES = 8;

__device__ __forceinline__ unsigned pkh(float lo, float hi) { f32x2 v = {lo, hi}; h2 b = __builtin_convertvector(v, h2); return __builtin_bit_cast(unsigned, b); }
__device__ __forceinline__ float ex2(float x) { return __builtin_amdgcn_exp2f(x); }
__device__ __forceinline__ float rcpf_(float x) { return __builtin_amdgcn_rcpf(x); }
__device__ __forceinline__ float silu_f(float g) { return g * rcpf_(1.0f + ex2(-LOG2E * g)); }
__device__ __forceinline__ float sigmoid_f(float g) { return rcpf_(1.0f + ex2(-LOG2E * g)); }
__device__ __forceinline__ float gelu_tanh(float y) { const float z = 0.7978845608028654f * (y + 0.044715f * y * y * y); return y * rcpf_(1.0f + ex2(-2.0f * LOG2E * z)); }

__device__ __forceinline__ float row_rs(const float* ssq, int row) {
    const f32x4* p = (const f32x4*)(ssq + (size_t)row * 16);
    const f32x4 a = p[0], b = p[1], c = p[2], d = p[3];
    const float s = (((a.x + a.y) + (a.z + a.w)) + ((b.x + b.y) + (b.z + b.w))) + (((c.x + c.y) + (c.z + c.w)) + ((d.x + d.y) + (d.z + d.w)));
    return 1.0f / sqrtf(s * (1.0f / 1024.0f) + RMS_EPS);
}

namespace pg8 {
constexpr int BM = 256, BK = 64, HALF = 128, HTB = HALF * BK * 2, STAGE_BYTES = 8 * HTB, NXCD = 8, WGM = 8;
__host__ __device__ __forceinline__ int lds_byte(int r, int c) { const int st = (r >> 4) * 2 + (c >> 5), rr = r & 15, cc = c & 31, ob = rr * 64 + cc * 2; return st * 1024 + (ob ^ (((ob >> 9) & 1) << 5)); }
__host__ __device__ __forceinline__ void stage_rc(int b, int& R, int& C) { const int st = b / 1024, sb = b % 1024, swz = sb ^ (((sb >> 9) & 1) << 5); R = (st >> 1) * 16 + swz / 64; C = (st & 1) * 32 + (swz % 64) / 2; }
__host__ __device__ __forceinline__ int perm32(int rho) { const int n = rho >> 4, i = rho & 15; return 8 * (i >> 2) + 4 * n + (i & 3); }

struct Unit { int pm, pn; };
struct Gemm { const f16* A; const f16* Bt; int M, N, K; };

struct StaticOrder {
    int nM, nN, nwg, G, c;
    __host__ __device__ void init(int M_, int N_, int G_, int c_) { nM = M_ / BM; nN = N_ / BM; nwg = nM * nN; G = G_; c = c_; }
    __host__ __device__ bool next(int i, Unit& u) const {
        const long L = (long)i * G + c; if (L >= nwg) return false;
        int wgid = (int)L; { const int q = nwg / NXCD, r = nwg % NXCD, xcd = wgid % NXCD, off = wgid / NXCD; wgid = (xcd < r ? xcd * (q + 1) : r * (q + 1) + (xcd - r) * q) + off; }
        const int nig = WGM * nN, gid = wgid / nig, fm = gid * WGM, gsz = (nM - fm) < WGM ? (nM - fm) : WGM;
        u.pm = fm + ((wgid % nig) % gsz); u.pn = (wgid % nig) / gsz; return true;
    }
    __device__ __forceinline__ void a_ready(const Unit&) const {}
    __device__ __forceinline__ void done(const Unit&) const {}
};


struct EpiSwiGLU {
    static constexpr bool PERM = true, AFTER_DRAIN = false;
    f16* O; const float* ssq;
    __device__ __forceinline__ void operator()(const f32x4 (&acc)[2][2][4][2], const Unit& u, int wr, int wc, int fr, int fq) const {
        const int row0 = u.pm * BM + wr * 64 + fr, col0 = u.pn * 128 + wc * 32 + 8 * fq;
#pragma unroll
        for (int ai = 0; ai < 2; ++ai)
#pragma unroll
            for (int m = 0; m < 4; ++m) {
                const int row = row0 + ai * HALF + m * 16; const float r = row_rs(ssq, row);
                const f32x4 g0 = acc[ai][0][m][0] * r, g1 = acc[ai][0][m][1] * r, u0 = acc[ai][1][m][0] * r, u1 = acc[ai][1][m][1] * r;
                u32x4 w;
                w.x = pkh(silu_f(g0[0]) * u0[0], silu_f(g0[1]) * u0[1]); w.y = pkh(silu_f(g0[2]) * u0[2], silu_f(g0[3]) * u0[3]);
                w.z = pkh(silu_f(g1[0]) * u1[0], silu_f(g1[1]) * u1[1]); w.w = pkh(silu_f(g1[2]) * u1[2], silu_f(g1[3]) * u1[3]);
                *(u32x4*)(O + (size_t)row * DFF + col0) = w;
            }
    }
};

struct EpiResid {
    static constexpr bool PERM = false, AFTER_DRAIN = false;
    const float* base_p; const float* base_s;
    float* out; f16* outh; float* ssq; float coef;
    __device__ __forceinline__ void operator()(const f32x4 (&acc)[2][2][4][2], const Unit& u, int wr, int wc, int fr, int fq) const {
        const int row0 = u.pm * BM + wr * 64 + fr, col0 = u.pn * BM + wc * 32 + 4 * fq;
        const float* bp = (u.pm * BM < MP) ? base_p : (base_s - (size_t)MP * DM);
#pragma unroll
        for (int ai = 0; ai < 2; ++ai)
#pragma unroll
            for (int m = 0; m < 4; ++m) {
                const int row = row0 + ai * HALF + m * 16; const size_t off = (size_t)row * DM + col0; float sq = 0.f;
#pragma unroll
                for (int bj = 0; bj < 2; ++bj)
#pragma unroll
                    for (int n = 0; n < 2; ++n) {
                        const size_t o2 = off + bj * HALF + n * 16;
                        const f32x4 b = *(const f32x4*)(bp + o2); const f32x4 o = b + acc[ai][bj][m][n] * coef;
                        *(f32x4*)(out + o2) = o; sq += (o[0] * o[0] + o[1] * o[1]) + (o[2] * o[2] + o[3] * o[3]);
                        if (outh) { u32x2 w; w.x = pkh(o[0], o[1]); w.y = pkh(o[2], o[3]); *(u32x2*)(outh + o2) = w; }
                    }
                if (ssq) { sq += __shfl_xor(sq, 16); sq += __shfl_xor(sq, 32); if (fq == 0) ssq[(size_t)row * 16 + u.pn * 4 + wc] = sq; }
            }
    }
};

struct EpiWin {
    static constexpr bool PERM = true, AFTER_DRAIN = false;
    f16 *MIX, *KH, *VH, *UH; const float* ssq; float* dout;
    __device__ __forceinline__ void operator()(const f32x4 (&acc)[2][2][4][2], const Unit& u, int wr, int wc, int fr, int fq) const {
        const int row0 = u.pm * BM + wr * 64 + fr, cw = wc * 32 + 8 * fq;
#pragma unroll
        for (int ai = 0; ai < 2; ++ai)
#pragma unroll
            for (int m = 0; m < 4; ++m) {
                const int row = row0 + ai * HALF + m * 16; const float r = row_rs(ssq, row);
#pragma unroll
                for (int bj = 0; bj < 2; ++bj) {
                    const f32x4 v0 = acc[ai][bj][m][0] * r, v1 = acc[ai][bj][m][1] * r;
                    u32x4 w; w.x = pkh(v0[0], v0[1]); w.y = pkh(v0[2], v0[3]); w.z = pkh(v1[0], v1[1]); w.w = pkh(v1[2], v1[3]);
                    f16* dst;
                    if (u.pn < 2) dst = MIX + (size_t)row * DM + u.pn * 256 + bj * HALF + cw;
                    else if (u.pn == 2) dst = (bj == 0 ? KH : VH) + (size_t)row * 128 + cw;
                    else dst = UH + (size_t)row * 512 + (u.pn - 3) * 256 + bj * HALF + cw;
                    *(u32x4*)dst = w;
                    if (u.pn == 2) {
                        float* fo = nullptr;
                        if (row >= MP) { const int s = row - MP, db = s >> 2, t = s & 3; fo = dout + (bj == 0 ? OUT_KS : OUT_VS) + ((size_t)(db * WBUF + (WBUF - DSEQ) + t)) * 128 + cw; }
                        else { const int t = row & (SEQ - 1), b = row >> 11; if (t >= SEQ - WBUF) fo = dout + (bj == 0 ? OUT_KP : OUT_VP) + ((size_t)(b * WBUF + (t - (SEQ - WBUF)))) * 128 + cw; }
                        if (fo) { *(f32x4*)fo = v0; *(f32x4*)(fo + 4) = v1; }
                    }
                }
            }
    }
};

struct EpiGlu {
    static constexpr bool PERM = true, AFTER_DRAIN = false;
    const f16* YG; f16* MIX; const float* bias;
    __device__ __forceinline__ void operator()(const f32x4 (&acc)[2][2][4][2], const Unit& u, int wr, int wc, int fr, int fq) const {
        const int row0 = u.pm * BM + wr * 64 + fr, col0 = u.pn * BM + wc * 32 + 8 * fq;
        f32x4 bv[2][2];
#pragma unroll
        for (int bj = 0; bj < 2; ++bj)
#pragma unroll
            for (int n = 0; n < 2; ++n) bv[bj][n] = *(const f32x4*)(bias + col0 + bj * HALF + 4 * n);
#pragma unroll
        for (int ai = 0; ai < 2; ++ai)
#pragma unroll
            for (int m = 0; m < 4; ++m) {
                const int row = row0 + ai * HALF + m * 16;
#pragma unroll
                for (int bj = 0; bj < 2; ++bj) {
                    const int col = col0 + bj * HALF;
                    const h8 y = *(const h8*)(YG + (size_t)row * 512 + col);
                    const f32x4 z0 = acc[ai][bj][m][0] + bv[bj][0], z1 = acc[ai][bj][m][1] + bv[bj][1];
                    u32x4 w;
                    w.x = pkh((float)y[0] * sigmoid_f(z0[0]), (float)y[1] * sigmoid_f(z0[1])); w.y = pkh((float)y[2] * sigmoid_f(z0[2]), (float)y[3] * sigmoid_f(z0[3]));
                    w.z = pkh((float)y[4] * sigmoid_f(z1[0]), (float)y[5] * sigmoid_f(z1[1])); w.w = pkh((float)y[6] * sigmoid_f(z1[2]), (float)y[7] * sigmoid_f(z1[3]));
                    *(u32x4*)(MIX + (size_t)row * DM + 512 + col) = w;
                }
            }
    }
};

template <class Epi, class Sched, bool ALIGN_EPI = false, bool SP2 = false>
__device__ __forceinline__ void gemm_phase(LAS unsigned char* lds, const Gemm g, const Sched& S, const Epi& E) {
    const int tid = threadIdx.x, wid = __builtin_amdgcn_readfirstlane(tid >> 6), lane = tid & 63, wr = wid >> 2, wc = wid & 3, fr = lane & 15, fq = lane >> 4;
    const int K = g.K, nt = K / BK;
    unsigned voffA[2], voffB[2];
#pragma unroll
    for (int i = 0; i < 2; ++i) { int R, C; stage_rc(tid * 16 + i * 8192, R, C); const int Rb = Epi::PERM ? ((R & ~31) + perm32(R & 31)) : R;
        voffA[i] = (unsigned)(R * K + C) * 2u; voffB[i] = (unsigned)(Rb * K + C) * 2u; }
    const size_t kstep = (size_t)(BK * 2);
    const size_t hstep = (size_t)HALF * K * 2;
    const size_t tstep = 2 * hstep;
    const unsigned ldsw = (unsigned)wid * 1024u;
    const int aoff = lds_byte(wr * 64 + fr, fq * 8), boff = lds_byte(wc * 32 + fr, fq * 8);
#define PG8_SA(b, h) (((b) * 2 + (h)) * HTB)
#define PG8_SB(b, h) ((4 + (b) * 2 + (h)) * HTB)
#define PG8_STAGE(bufoff, gbase, voff) do { _Pragma("unroll") for (int _i = 0; _i < 2; ++_i) \
        __builtin_amdgcn_global_load_lds((const unsigned*)((const char*)(gbase) + (voff)[_i]), (LAS unsigned*)(lds + (bufoff) + ldsw + _i * 8192), 16, 0, 0); } while (0)
#define PG8_LDA(dst, b, h) do { _Pragma("unroll") for (int m = 0; m < 4; ++m) _Pragma("unroll") for (int k = 0; k < 2; ++k) dst[m][k] = *(const LAS h8*)(lds + PG8_SA(b, h) + aoff + m * 2048 + k * 1024); } while (0)
#define PG8_LDB(dst, b, h) do { _Pragma("unroll") for (int n = 0; n < 2; ++n) _Pragma("unroll") for (int k = 0; k < 2; ++k) dst[n][k] = *(const LAS h8*)(lds + PG8_SB(b, h) + boff + n * 2048 + k * 1024); } while (0)
#define PG8_MMA(ai, bj, At, Bt) do { __builtin_amdgcn_s_setprio(1); _Pragma("unroll") for (int m = 0; m < 4; ++m) _Pragma("unroll") for (int n = 0; n < 2; ++n) _Pragma("unroll") for (int k = 0; k < 2; ++k) \
        acc[ai][bj][m][n] = __builtin_amdgcn_mfma_f32_16x16x32_f16(Bt[n][k], At[m][k], acc[ai][bj][m][n], 0, 0, 0); __builtin_amdgcn_s_setprio(0); } while (0)
#define PG8_WAIT_V(n) asm volatile("s_waitcnt vmcnt(" #n ")" ::: "memory")
#define PG8_WAIT_L(n) asm volatile("s_waitcnt lgkmcnt(" #n ")" ::: "memory")
#define PG8_BAR __builtin_amdgcn_s_barrier()
#define PG8_SCHED __builtin_amdgcn_sched_barrier(0)
    Unit cur, nxt; int ui = 0;
    if (!S.next(0, cur)) return;
    f32x4 acc[2][2][4][2];
#pragma unroll
    for (int a = 0; a < 2; ++a)
#pragma unroll
        for (int b = 0; b < 2; ++b)
#pragma unroll
            for (int m = 0; m < 4; ++m)
#pragma unroll
                for (int n = 0; n < 2; ++n) acc[a][b][m][n] = (f32x4){0.f, 0.f, 0.f, 0.f};
    h8 At[4][2], B0[2][2], B1[2][2];
    const char* cA = (const char*)g.A + (size_t)cur.pm * tstep; const char* cB = (const char*)g.Bt + (size_t)cur.pn * tstep;
    S.a_ready(cur);
    if constexpr (SP2) {
        PG8_STAGE(PG8_SB(0, 0), cB, voffB); PG8_STAGE(PG8_SB(0, 1), cB + hstep, voffB); PG8_STAGE(PG8_SA(0, 0), cA, voffA); PG8_STAGE(PG8_SA(0, 1), cA + hstep, voffA);
        if (wr == 1) PG8_BAR;
        PG8_WAIT_V(2); PG8_BAR;
        PG8_STAGE(PG8_SB(1, 0), cB + kstep, voffB); PG8_STAGE(PG8_SA(1, 0), cA + kstep, voffA); PG8_STAGE(PG8_SB(1, 1), cB + hstep + kstep, voffB);
        PG8_WAIT_V(6); PG8_BAR;
    } else {
        PG8_STAGE(PG8_SB(0, 0), cB, voffB); PG8_STAGE(PG8_SA(0, 0), cA, voffA); PG8_STAGE(PG8_SB(0, 1), cB + hstep, voffB); PG8_STAGE(PG8_SA(0, 1), cA + hstep, voffA);
        if (wr == 1) PG8_BAR;
        PG8_WAIT_V(4); PG8_BAR;
        PG8_STAGE(PG8_SB(1, 0), cB + kstep, voffB); PG8_STAGE(PG8_SA(1, 0), cA + kstep, voffA); PG8_STAGE(PG8_SB(1, 1), cB + hstep + kstep, voffB);
        PG8_WAIT_V(6); PG8_BAR;
    }
    for (;;) {
        const bool has_next = S.next(ui + 1, nxt);
        const char* nA = has_next ? (const char*)g.A + (size_t)nxt.pm * tstep : cA; const char* nB = has_next ? (const char*)g.Bt + (size_t)nxt.pn * tstep : cB;
        for (int t = 0; t < nt; t += 2) {
            const bool last = (t == nt - 2);
            const char* a1 = cA + (size_t)(t + 1) * kstep;
            const char* a2 = last ? nA : cA + (size_t)(t + 2) * kstep; const char* b2 = last ? nB : cB + (size_t)(t + 2) * kstep;
            const char* a3 = a2 + kstep; const char* b3 = b2 + kstep;
            if (last && has_next) S.a_ready(nxt);
            if constexpr (SP2) {
            PG8_LDB(B0, 0, 0); PG8_LDB(B1, 0, 1); PG8_SCHED; PG8_LDA(At, 0, 0); PG8_STAGE(PG8_SA(1, 1), a1 + hstep, voffA);
            PG8_WAIT_V(8); PG8_WAIT_L(0); PG8_BAR; PG8_MMA(0, 0, At, B0); PG8_MMA(0, 1, At, B1); PG8_BAR; PG8_SCHED;
            PG8_LDA(At, 0, 1); PG8_STAGE(PG8_SB(0, 0), b2, voffB); PG8_STAGE(PG8_SB(0, 1), b2 + hstep, voffB); PG8_STAGE(PG8_SA(0, 0), a2, voffA);
            PG8_WAIT_V(8); PG8_WAIT_L(0); PG8_BAR; PG8_MMA(1, 0, At, B0); PG8_MMA(1, 1, At, B1); PG8_BAR; PG8_SCHED;
            PG8_LDB(B0, 1, 0); PG8_LDB(B1, 1, 1); PG8_SCHED; PG8_LDA(At, 1, 0); PG8_STAGE(PG8_SA(0, 1), a2 + hstep, voffA);
            PG8_WAIT_V(8); PG8_WAIT_L(0); PG8_BAR; PG8_MMA(0, 0, At, B0); PG8_MMA(0, 1, At, B1); PG8_BAR; PG8_SCHED;
            PG8_LDA(At, 1, 1); PG8_STAGE(PG8_SB(1, 0), b3, voffB); PG8_STAGE(PG8_SB(1, 1), b3 + hstep, voffB); PG8_STAGE(PG8_SA(1, 0), a3, voffA);
            PG8_WAIT_V(8); PG8_WAIT_L(0); PG8_BAR; PG8_MMA(1, 0, At, B0); PG8_MMA(1, 1, At, B1); PG8_BAR; PG8_SCHED;
            } else {
            PG8_LDB(B0, 0, 0); PG8_SCHED; PG8_LDA(At, 0, 0); PG8_STAGE(PG8_SA(1, 1), a1 + hstep, voffA);
            PG8_WAIT_L(8); PG8_BAR; PG8_WAIT_L(0); PG8_MMA(0, 0, At, B0); PG8_BAR; PG8_SCHED;
            PG8_LDB(B1, 0, 1); PG8_STAGE(PG8_SB(0, 0), b2, voffB);
            PG8_BAR; PG8_WAIT_L(0); PG8_MMA(0, 1, At, B1); PG8_BAR;
            PG8_LDA(At, 0, 1); PG8_STAGE(PG8_SA(0, 0), a2, voffA);
            PG8_BAR; PG8_WAIT_L(0); PG8_MMA(1, 0, At, B0); PG8_BAR; PG8_SCHED;
            PG8_STAGE(PG8_SB(0, 1), b2 + hstep, voffB);
            PG8_WAIT_V(6); PG8_BAR; PG8_MMA(1, 1, At, B1); PG8_BAR;
            PG8_LDB(B0, 1, 0); PG8_SCHED; PG8_LDA(At, 1, 0); PG8_STAGE(PG8_SA(0, 1), a2 + hstep, voffA);
            PG8_WAIT_L(8); PG8_BAR; PG8_WAIT_L(0); PG8_MMA(0, 0, At, B0); PG8_BAR; PG8_SCHED;
            PG8_LDB(B1, 1, 1); PG8_STAGE(PG8_SB(1, 0), b3, voffB);
            PG8_BAR; PG8_WAIT_L(0); PG8_MMA(0, 1, At, B1); PG8_BAR;
            PG8_LDA(At, 1, 1); PG8_STAGE(PG8_SA(1, 0), a3, voffA);
            PG8_BAR; PG8_WAIT_L(0); PG8_MMA(1, 0, At, B0); PG8_BAR; PG8_SCHED;
            PG8_STAGE(PG8_SB(1, 1), b3 + hstep, voffB);
            PG8_WAIT_V(6); PG8_BAR; PG8_MMA(1, 1, At, B1); PG8_BAR;
            }
        }
        if constexpr (ALIGN_EPI) { if (wr == 0) PG8_BAR; }
        if constexpr (!Epi::AFTER_DRAIN) { E(acc, cur, wr, wc, fr, fq); S.done(cur); }
        if (!has_next) break;
#pragma unroll
        for (int a = 0; a < 2; ++a)
#pragma unroll
            for (int b = 0; b < 2; ++b)
#pragma unroll
                for (int m = 0; m < 4; ++m)
#pragma unroll
                    for (int n = 0; n < 2; ++n) acc[a][b][m][n] = (f32x4){0.f, 0.f, 0.f, 0.f};
        cur = nxt; cA = nA; cB = nB; ++ui;
        if constexpr (ALIGN_EPI) { if (wr == 1) PG8_BAR; }
    }
    PG8_WAIT_V(0);
    if constexpr (!ALIGN_EPI) { if (wr == 0) PG8_BAR; }
    PG8_BAR;
#undef PG8_SA
#undef PG8_SB
#undef PG8_STAGE
#undef PG8_LDA
#undef PG8_LDB
#undef PG8_MMA
#undef PG8_WAIT_V
#undef PG8_WAIT_L
#undef PG8_BAR
#undef PG8_SCHED
}
}

typedef GAS unsigned gu32;
#define RLX_AGENT __ATOMIC_RELAXED, __HIP_MEMORY_SCOPE_AGENT
#define LDS_WAIT() asm volatile("s_waitcnt lgkmcnt(0)" ::: "memory")
#define VM_WAIT() asm volatile("s_waitcnt vmcnt(0)" ::: "memory")
#define XB_TMO      128
#define XB_XCNT(j)  (256  + 64 * (j))
#define XB_XSUB(j)  (1280 + 64 * (j))
#define XB_XGEN(j)  (2304 + 64 * (j))
#define XB_TOP      3328
#define XB_TOPGEN   3392
#define XCD_BAR_WORDS 3456
#define XB_SPIN_CAP (1u << 18)
__device__ __forceinline__ unsigned xb_ld(unsigned* p)              { return __hip_atomic_load(p, __ATOMIC_RELAXED, __HIP_MEMORY_SCOPE_AGENT); }
__device__ __forceinline__ unsigned xb_add(unsigned* p, unsigned v) { return __hip_atomic_fetch_add(p, v, __ATOMIC_RELAXED, __HIP_MEMORY_SCOPE_AGENT); }
__device__ __forceinline__ unsigned xb_xcc_id() { return (unsigned)__builtin_amdgcn_s_getreg((3 << 11) | 20) & 0xFu; }
#define XB_SPIN(cond, bar) do { unsigned _sp = 0; while (cond) { __builtin_amdgcn_s_sleep(1); \
    if ((++_sp & 255u) == 0u) { if (xb_ld(&(bar)[XB_TMO])) break; if (_sp > XB_SPIN_CAP) { atomicAdd(&(bar)[XB_TMO], 1u); break; } } } } while (0)
struct XcdBarrier { unsigned* bar; unsigned x; volatile LAS unsigned* st; };
__device__ __forceinline__ XcdBarrier xcd_barrier_post(unsigned* bar, volatile LAS unsigned* st) {
    XcdBarrier b; b.bar = bar; b.x = xb_xcc_id(); b.st = st;
    if (threadIdx.x == 0) (void)xb_add(&bar[XB_XCNT(b.x)], 1u);
    return b;
}
__device__ __forceinline__ void xcd_barrier_complete(unsigned* bar, unsigned x, unsigned& nloc, unsigned& nx) {
    const unsigned G = gridDim.x * gridDim.y * gridDim.z;
    unsigned sum, cnt, mine, sp = 0u;
    for (;;) {
        sum = 0u; cnt = 0u; mine = 0u;
#pragma unroll
        for (unsigned j = 0; j < 16; ++j) { const unsigned c = xb_ld(&bar[XB_XCNT(j)]); sum += c; cnt += (c > 0u) ? 1u : 0u; mine = (j == x) ? c : mine; }
        if (sum == G) break;
        __builtin_amdgcn_s_sleep(1);
        if ((++sp & 255u) == 0u) { if (xb_ld(&bar[XB_TMO])) break; if (sp > XB_SPIN_CAP) { atomicAdd(&bar[XB_TMO], 1u); break; } }
    }
    nloc = mine > 0u ? mine : 1u; nx = cnt > 0u ? cnt : 1u;
}
__device__ __forceinline__ void xcd_barrier(const XcdBarrier& b) {
    asm volatile("s_waitcnt vmcnt(0)" ::: "memory");
    __syncthreads();
    if (threadIdx.x == 0) {
        unsigned* bar = b.bar;
        __builtin_amdgcn_s_waitcnt(0);
        unsigned nloc = b.st[0], nx = b.st[1];
        if (nloc == 0u) { xcd_barrier_complete(bar, b.x, nloc, nx); b.st[0] = nloc; b.st[1] = nx; }
        const unsigned old = xb_add(&bar[XB_XSUB(b.x)], 1u);
        const unsigned gen = old / nloc;
        if (old + 1u == (gen + 1u) * nloc) {
            __builtin_amdgcn_fence(__ATOMIC_RELEASE, "agent");
            asm volatile("s_waitcnt vmcnt(0)" ::: "memory");
            const unsigned og = xb_add(&bar[XB_TOP], 1u);
            const unsigned tg = og / nx;
            if (og + 1u == (tg + 1u) * nx) xb_add(&bar[XB_TOPGEN], 1u);
            else XB_SPIN(xb_ld(&bar[XB_TOPGEN]) == tg, bar);
            __builtin_amdgcn_fence(__ATOMIC_ACQUIRE, "agent");
            xb_add(&bar[XB_XGEN(b.x)], 1u);
            asm volatile("s_waitcnt vmcnt(0)" ::: "memory");
        } else {
            XB_SPIN(xb_ld(&bar[XB_XGEN(b.x)]) == gen, bar);
            __builtin_amdgcn_fence(__ATOMIC_ACQUIRE, "agent");
            asm volatile("s_waitcnt vmcnt(0)" ::: "memory");
        }
    }
    __syncthreads();
}

struct Args {
    const float* in[30]; float* out; unsigned char* ws; int ph_lo, ph_hi;
};
struct Frame {
    LAS unsigned char* lds; volatile LAS unsigned* MISC; unsigned* ctl;
    int tid, lane, wave, vcu, G;
};

__device__ __forceinline__ void p0_tr_item(const float* W, int K, int N, f16* WT, int dst_row0, const float* gain, float scale, LAS float* scr, int k0, int n0, int lane) {
#pragma unroll 8
    for (int i = 0; i < 32; ++i) { const int kk = 2 * i + (lane >> 5); float v = W[(size_t)(k0 + kk) * N + n0 + (lane & 31)]; if (gain) v *= gain[k0 + kk]; scr[kk * 33 + (lane & 31)] = v * scale; }
    LDS_WAIT(); asm volatile("" ::: "memory");
    const int c = lane & 7;
#pragma unroll
    for (int j = 0; j < 4; ++j) { const int n = (lane >> 3) + 8 * j; const LAS float* s = scr + (8 * c) * 33 + n;
        u32x4 o; o.x = pkh(s[0 * 33], s[1 * 33]); o.y = pkh(s[2 * 33], s[3 * 33]); o.z = pkh(s[4 * 33], s[5 * 33]); o.w = pkh(s[6 * 33], s[7 * 33]);
        *(u32x4*)(WT + (size_t)(dst_row0 + n) * K + k0 + 8 * c) = o; }
    LDS_WAIT(); asm volatile("" ::: "memory");
}
__device__ __forceinline__ float wave_sum(float v) {
#pragma unroll
    for (int o = 1; o < 64; o <<= 1) v += __shfl_xor(v, o);
    return v;
}
__device__ __forceinline__ double d_exp(double x) {
    const double n = __builtin_rint(x * 1.4426950408889634074); const double r = (x - n * 0.693147180369123816490) - n * 1.90821492927058770002e-10;
    double p = 1.0 / 6227020800.0;
    p = p * r + 1.0 / 479001600.0; p = p * r + 1.0 / 39916800.0; p = p * r + 1.0 / 3628800.0; p = p * r + 1.0 / 362880.0; p = p * r + 1.0 / 40320.0; p = p * r + 1.0 / 5040.0;
    p = p * r + 1.0 / 720.0; p = p * r + 1.0 / 120.0; p = p * r + 1.0 / 24.0; p = p * r + 1.0 / 6.0; p = p * r + 0.5; p = p * r + 1.0; p = p * r + 1.0;
    return __builtin_ldexp(p, (int)n);
}
__device__ __forceinline__ void d_sincos(double x, double& s, double& c) {
    const double n = __builtin_rint(x * 0.63661977236758134308); const double r = (x - n * 1.57079632673412561417) - n * 6.07710050650619224932e-11;
    const double r2 = r * r;
    double ps = -1.0 / 1307674368000.0; ps = ps * r2 + 1.0 / 6227020800.0; ps = ps * r2 - 1.0 / 39916800.0; ps = ps * r2 + 1.0 / 362880.0; ps = ps * r2 - 1.0 / 5040.0; ps = ps * r2 + 1.0 / 120.0; ps = ps * r2 - 1.0 / 6.0; ps = ps * r2 + 1.0; ps *= r;
    double pc = 1.0 / 20922789888000.0; pc = pc * r2 - 1.0 / 87178291200.0; pc = pc * r2 + 1.0 / 479001600.0; pc = pc * r2 - 1.0 / 3628800.0; pc = pc * r2 + 1.0 / 40320.0; pc = pc * r2 - 1.0 / 720.0; pc = pc * r2 + 1.0 / 24.0; pc = pc * r2 - 0.5; pc = pc * r2 + 1.0;
    const int q = ((int)n) & 3;
    s = (q == 0) ? ps : (q == 1) ? pc : (q == 2) ? -ps : -pc;
    c = (q == 0) ? pc : (q == 1) ? -ps : (q == 2) ? -pc : ps;
}

__device__ __forceinline__ void ssm_precompute(const Frame& F, const Args& a, int g) {
    LAS float* pwr = (LAS float*)F.lds; LAS float* pwi = pwr + 17 * 64; LAS float* fr_ = pwi + 17 * 64; LAS float* fi_ = fr_ + 64;
    LAS float* bbr = fi_ + 64; LAS float* bbi = bbr + 1024; LAS float* cr_ = bbi + 1024; LAS float* ci_ = cr_ + 1024;
    const float* log_dt = a.in[14]; const float* a_re = a.in[15]; const float* a_im = a.in[16]; const float* b_re = a.in[17]; const float* b_im = a.in[18];
    const float* c_re = a.in[19]; const float* c_im = a.in[20];
    unsigned char* blk = a.ws + WS_SSM + (size_t)g * SSM_STRIDE;
    f16* W2h = (f16*)(blk + SSM_W2); f16* W3h = (f16*)(blk + SSM_W3); f16* Kgh = (f16*)(blk + SSM_KG); float* cst = (float*)(blk + SSM_CONST);
    const int tid = F.tid;
    const double dt = d_exp((double)log_dt[g]);
    if (tid < 64) {
        const int p = tid; const double lr = (double)a_re[g * 64 + p], li = (double)a_im[g * 64 + p];
        double sn, cs; d_sincos(li * dt, sn, cs); const double mag = d_exp(lr * dt);
        const double br = mag * cs, bi = mag * sn;
        const double nr = br - 1.0, ni = bi, dr = lr * dt, di = li * dt, dn = dr * dr + di * di;
        fr_[p] = (float)((nr * dr + ni * di) / dn); fi_[p] = (float)((ni * dr - nr * di) / dn);
        double xr = 1.0, xi = 0.0;
        for (int d = 0; d <= 16; ++d) { pwr[d * 64 + p] = (float)xr; pwi[d * 64 + p] = (float)xi;
            if (d == 4) { cst[128 + p] = (float)xr; cst[192 + p] = (float)xi; }
            if (d == 16) { cst[p] = (float)xr; cst[64 + p] = (float)xi; }
            const double t = xr * br - xi * bi; xi = xr * bi + xi * br; xr = t; }
        if (p == 0) cst[256] = (float)dt;
        double l16r = 1.0, l16i = 0.0;
        for (int d = 0; d < 16; ++d) { const double t = l16r * br - l16i * bi; l16i = l16r * bi + l16i * br; l16r = t; }
        double yr = 1.0, yi = 0.0;
        for (int j = 0; j <= 16; ++j) { cst[320 + j * 64 + p] = (float)yr; cst[320 + 17 * 64 + j * 64 + p] = (float)yi;
            const double t = yr * l16r - yi * l16i; yi = yr * l16i + yi * l16r; yr = t; }
    }
    __syncthreads();
    for (int e = tid; e < 1024; e += 512) { const int p = e >> 4, c = e & 15;
        const float brr = b_re[(g * 64 + p) * 16 + c], bii = b_im[(g * 64 + p) * 16 + c];
        bbr[e] = fr_[p] * brr - fi_[p] * bii; bbi[e] = fr_[p] * bii + fi_[p] * brr;
        const int c2 = e >> 6, p2 = e & 63; cr_[e] = c_re[(g * 16 + c2) * 64 + p2]; ci_[e] = c_im[(g * 16 + c2) * 64 + p2]; }
    __syncthreads();
    for (int e = tid; e < 128 * 256; e += 512) { const int col = e & 255, k = e >> 8, s = col >> 4, c = col & 15, part = k >> 6, p = k & 63;
        const float wr_ = pwr[(15 - s) * 64 + p], wi_ = pwi[(15 - s) * 64 + p], xr = bbr[p * 16 + c], xi = bbi[p * 16 + c];
        const float v = part == 0 ? (wr_ * xr - wi_ * xi) : (wr_ * xi + wi_ * xr); W2h[e] = (f16)v; }
    for (int e = tid; e < 256 * 128; e += 512) { const int pos = e & 127, row = e >> 7, t = row >> 4, c = row & 15, k4 = pos >> 5, w = pos & 31, q = w >> 3, j = w & 7;
        const int k = 32 * k4 + 16 * (j >> 2) + 4 * q + (j & 3), part = k >> 6, p = k & 63;
        const float wr_ = pwr[(t + 1) * 64 + p], wi_ = pwi[(t + 1) * 64 + p], xr = cr_[c * 64 + p], xi = ci_[c * 64 + p];
        const float v = part == 0 ? (wr_ * xr - wi_ * xi) : -(wr_ * xi + wi_ * xr); W3h[e] = (f16)v; }
    for (int e = tid; e < 4096; e += 512) { const int d = e >> 8, c = (e >> 4) & 15, c2 = e & 15; float s = 0.f;
        for (int p = 0; p < 64; ++p) { const float wr_ = pwr[d * 64 + p], wi_ = pwi[d * 64 + p], xr = cr_[c * 64 + p], xi = ci_[c * 64 + p];
            const float tr = wr_ * xr - wi_ * xi, ti = wr_ * xi + wi_ * xr; s += tr * bbr[p * 16 + c2] - ti * bbi[p * 16 + c2]; }
        Kgh[e] = (f16)s; }
    __syncthreads();
}

__device__ __forceinline__ void p0_prologue(const Frame& F, const Args& a) {
    if ((F.vcu & 7) == 0 && (F.vcu >> 3) < NG) ssm_precompute(F, a, F.vcu >> 3);
    if (F.vcu == F.G - 1) {
        float* tb = (float*)(a.ws + WS_TB); const float* rel = a.in[6]; const float* sinks = a.in[13];
        for (int e = F.tid; e < 8 * 384; e += 512) { const int h = e / 384, idx = e % 384, d = 127 - (idx - 128); float v = -1e30f;
            if (d >= 0 && d < 128) { int bk = d; if (d >= 16) { bk = 16 + (int)(logf((float)d / 16.0f) / 2.0794415416798357f * 16.0f); bk = bk > 31 ? 31 : bk; } v = rel[bk * 8 + h] * LOG2E; }
            tb[e] = v; }
        if (F.tid < 8) tb[8 * 384 + F.tid] = sinks[F.tid] * LOG2E;
    }
    __syncthreads();
    LAS float* scr = (LAS float*)(F.lds + F.wave * 16384);
    const int gw = F.vcu * NWAVES + F.wave, NGW = F.G * NWAVES;
    constexpr int I_UP = (DM / 64) * (DFF / 32), I_DN = (DFF / 64) * (DM / 32), I_IN = (DM / 64) * (DIN / 32), I_GLU = (512 / 64) * (512 / 32), I_OUT = (DM / 64) * (DM / 32);
    constexpr int NITEMS = 4 * I_UP + 2 * I_DN + I_IN + I_GLU + I_OUT;
    for (int it = gw; it < NITEMS; it += NGW) {
        int r = it;
        bool done = false;
#pragma unroll
        for (int q = 0; q < 4; ++q) {
            if (!done && r < I_UP) { const int nblk = DFF / 32, kb = r / nblk, nb = r % nblk, n0 = 32 * nb;
                const float* W = a.in[q == 0 ? 8 : q == 1 ? 9 : q == 2 ? 26 : 27]; const float* gain = a.in[q < 2 ? 7 : 25]; f16* WT = (f16*)(a.ws + (q < 2 ? WS_W1A : WS_W2A));
                p0_tr_item(W, DM, DFF, WT, (n0 >> 7) * 256 + (n0 & 127) + ((q & 1) ? 128 : 0) - 0, gain, 1.0f, scr, 64 * kb, n0, F.lane); done = true; }
            if (!done) r -= I_UP;
        }
        if (done) continue;
        if (r < 2 * I_DN) { const int q = r / I_DN; r -= q * I_DN; const int nblk = DM / 32, kb = r / nblk, nb = r % nblk;
            p0_tr_item(a.in[q == 0 ? 10 : 28], DFF, DM, (f16*)(a.ws + (q == 0 ? WS_W1D : WS_W2D)), 32 * nb, nullptr, 1.0f, scr, 64 * kb, 32 * nb, F.lane); continue; }
        r -= 2 * I_DN;
        if (r < I_IN) { const int nblk = DIN / 32, kb = r / nblk, nb = r % nblk, n0 = 32 * nb;
            p0_tr_item(a.in[12], DM, DIN, (f16*)(a.ws + WS_WIN), n0, a.in[11], n0 < DATT ? QSCALE : 1.0f, scr, 64 * kb, n0, F.lane); continue; }
        r -= I_IN;
        if (r < I_GLU) { const int nblk = 512 / 32, kb = r / nblk, nb = r % nblk;
            p0_tr_item(a.in[22], 512, 512, (f16*)(a.ws + WS_WGLU), 32 * nb, nullptr, 1.0f, scr, 64 * kb, 32 * nb, F.lane); continue; }
        r -= I_GLU;
        { const int nblk = DM / 32, kb = r / nblk, nb = r % nblk;
            p0_tr_item(a.in[24], DM, DM, (f16*)(a.ws + WS_WOUT), 32 * nb, nullptr, 1.0f, scr, 64 * kb, 32 * nb, F.lane); }
    }
    f16* XH = (f16*)(a.ws + WS_XH); float* ssq1 = (float*)(a.ws + WS_SSQ1);
    for (int m = gw; m < M; m += NGW) {
        const float* xrow = (m < MP) ? a.in[0] + (size_t)m * DM : a.in[1] + (size_t)(m - MP) * DM;
        const f32x4* xr = (const f32x4*)xrow + F.lane; f32x4 v[4]; float s = 0.f;
#pragma unroll
        for (int j = 0; j < 4; ++j) { v[j] = xr[64 * j]; s += (v[j].x * v[j].x + v[j].y * v[j].y) + (v[j].z * v[j].z + v[j].w * v[j].w); }
        s = wave_sum(s);
        u32x2* o8 = (u32x2*)(XH + (size_t)m * DM) + F.lane;
#pragma unroll
        for (int j = 0; j < 4; ++j) { u32x2 w; w.x = pkh(v[j].x, v[j].y); w.y = pkh(v[j].z, v[j].w); o8[64 * j] = w; }
        if (F.lane < 16) ssq1[(size_t)m * 16 + F.lane] = (F.lane == 0) ? s : 0.f;
    }
}

namespace att {
constexpr int KSTR = 144;
constexpr int OFF_K = 0, OFF_V = 256 * KSTR, OFF_TB = 2 * 256 * KSTR;
__device__ __forceinline__ h8 vt_frag(const LAS unsigned char* vbase, int keybase, int dt, int lane) {
    const int i = lane & 15, kq = lane >> 4;
    const LAS unsigned char* p0 = vbase + (keybase + 4 * kq + (i >> 2)) * KSTR + (16 * dt + 4 * (i & 3)) * 2;
    const v4i16_t lo = __builtin_amdgcn_ds_read_tr16_b64_v4i16((LAS v4i16_t*)p0);
    const v4i16_t hi = __builtin_amdgcn_ds_read_tr16_b64_v4i16((LAS v4i16_t*)(p0 + 16 * KSTR));
    typedef short s8 __attribute__((ext_vector_type(8)));
    const s8 r = {lo[0], lo[1], lo[2], lo[3], hi[0], hi[1], hi[2], hi[3]};
    return __builtin_bit_cast(h8, r);
}

__device__ __forceinline__ void prompt_unit(const Frame& F, const Args& a, int b, int n, int gkv) {
    f16* MIX = (f16*)(a.ws + WS_MIX); const f16* KH = (const f16*)(a.ws + WS_KH); const f16* VH = (const f16*)(a.ws + WS_VH); const float* tbg = (const float*)(a.ws + WS_TB);
    LAS unsigned char* lds = F.lds; const int tid = F.tid, lane = F.lane, wid = F.wave, q = lane & 15, quad = lane >> 4;
#pragma unroll
    for (int it = 0; it < 4; ++it) { const int piece = it * 512 + tid, key = piece >> 3, ch = piece & 7;
        if (n > 0 || key >= 128) { const size_t row = (size_t)b * SEQ + (n - 1) * 128 + key;
            const u32x4 kv = *(const u32x4*)(KH + row * 128 + gkv * 64 + ch * 8); const u32x4 vv = *(const u32x4*)(VH + row * 128 + gkv * 64 + ch * 8);
            *(LAS u32x4*)(lds + OFF_K + key * KSTR + ch * 16) = kv; *(LAS u32x4*)(lds + OFF_V + key * KSTR + ch * 16) = vv; } }
    for (int e = tid; e < 4 * 384; e += 512) ((LAS float*)(lds + OFF_TB))[e] = tbg[gkv * 4 * 384 + e];
    __syncthreads();
    const int r = wid >> 1, qh = wid & 1, h = 4 * gkv + r;
    const size_t tok0 = (size_t)b * SEQ + n * 128 + 64 * qh;
    h8 Qf[4][2];
#pragma unroll
    for (int jq = 0; jq < 4; ++jq)
#pragma unroll
        for (int st = 0; st < 2; ++st) Qf[jq][st] = *(const h8*)(MIX + (tok0 + 16 * jq + q) * DM + h * 64 + 32 * st + 8 * quad);
    const float sink = tbg[8 * 384 + h];
    float mrun[4], lrun[4]; f32x4 o[4][4];
#pragma unroll
    for (int jq = 0; jq < 4; ++jq) { mrun[jq] = sink; lrun[jq] = (quad == 0) ? 1.0f : 0.0f;
#pragma unroll
        for (int dt = 0; dt < 4; ++dt) o[dt][jq] = (f32x4){0.f, 0.f, 0.f, 0.f}; }
    const LAS float* tb = (const LAS float*)(lds + OFF_TB) + r * 384;
#pragma unroll 1
    for (int kt = 2 * qh; kt <= 2 * qh + 5; ++kt) {
        if (n == 0 && kt < 4) continue;
        f32x4 s[2][4];
#pragma unroll
        for (int i = 0; i < 2; ++i) {
            const LAS unsigned char* kp = lds + OFF_K + (32 * kt + 16 * i + q) * KSTR + 16 * quad;
            const h8 k0 = *(const LAS h8*)kp, k1 = *(const LAS h8*)(kp + 64);
#pragma unroll
            for (int jq = 0; jq < 4; ++jq) { f32x4 c = __builtin_amdgcn_mfma_f32_16x16x32_f16(k0, Qf[jq][0], (f32x4){0.f, 0.f, 0.f, 0.f}, 0, 0, 0);
                s[i][jq] = __builtin_amdgcn_mfma_f32_16x16x32_f16(k1, Qf[jq][1], c, 0, 0, 0); }
        }
#pragma unroll
        for (int jq = 0; jq < 4; ++jq) {
            const int ib = 32 * kt + 4 * quad - (64 * qh + 16 * jq + q) - 1 + 128;
            float mx = -3.0e38f;
#pragma unroll
            for (int i = 0; i < 2; ++i)
#pragma unroll
                for (int rr = 0; rr < 4; ++rr) { const float v = s[i][jq][rr] + tb[ib + 16 * i + rr]; s[i][jq][rr] = v; mx = fmaxf(mx, v); }
            mx = fmaxf(mx, __shfl_xor(mx, 16)); mx = fmaxf(mx, __shfl_xor(mx, 32));
            const float mnew = fmaxf(mrun[jq], mx), alpha = ex2(mrun[jq] - mnew); mrun[jq] = mnew;
            float ls = lrun[jq] * alpha;
#pragma unroll
            for (int dt = 0; dt < 4; ++dt) o[dt][jq] = o[dt][jq] * alpha;
#pragma unroll
            for (int i = 0; i < 2; ++i)
#pragma unroll
                for (int rr = 0; rr < 4; ++rr) { const float p = ex2(s[i][jq][rr] - mnew); s[i][jq][rr] = p; ls += p; }
            lrun[jq] = ls;
        }
        h8 Pf[4];
#pragma unroll
        for (int jq = 0; jq < 4; ++jq) { u32x4 w; w.x = pkh(s[0][jq][0], s[0][jq][1]); w.y = pkh(s[0][jq][2], s[0][jq][3]);
            w.z = pkh(s[1][jq][0], s[1][jq][1]); w.w = pkh(s[1][jq][2], s[1][jq][3]); Pf[jq] = __builtin_bit_cast(h8, w); }
#pragma unroll
        for (int dt = 0; dt < 4; ++dt) { const h8 vf = vt_frag(lds + OFF_V, 32 * kt, dt, lane);
#pragma unroll
            for (int jq = 0; jq < 4; ++jq) o[dt][jq] = __builtin_amdgcn_mfma_f32_16x16x32_f16(vf, Pf[jq], o[dt][jq], 0, 0, 0); }
    }
#pragma unroll
    for (int jq = 0; jq < 4; ++jq) { float lt = lrun[jq]; lt += __shfl_xor(lt, 16); lt += __shfl_xor(lt, 32); const float inv = 1.0f / lt;
        f16* op = MIX + (tok0 + 16 * jq + q) * DM + h * 64 + 4 * quad;
#pragma unroll
        for (int dt = 0; dt < 4; ++dt) { const f32x4 v = o[dt][jq] * inv; u32x2 w; w.x = pkh(v[0], v[1]); w.y = pkh(v[2], v[3]); *(u32x2*)(op + 16 * dt) = w; } }
    __syncthreads();
}

__device__ __forceinline__ void sample_unit(const Frame& F, const Args& a, int db, int gkv) {
    f16* MIX = (f16*)(a.ws + WS_MIX); const f16* KH = (const f16*)(a.ws + WS_KH); const f16* VH = (const f16*)(a.ws + WS_VH); const float* tbg = (const float*)(a.ws + WS_TB);
    const float* ck = a.in[2]; const float* cv = a.in[3];
    LAS unsigned char* lds = F.lds; const int tid = F.tid, lane = F.lane, wid = F.wave, q = lane & 15, quad = lane >> 4;
#pragma unroll
    for (int it = 0; it < 4; ++it) { const int piece = it * 512 + tid, j = piece >> 4, ch = piece & 15;
        const size_t off = ((size_t)(db * WBUF + j) * 2 + gkv) * 64 + ch * 4;
        const f32x4 kv = *(const f32x4*)(ck + off), vv = *(const f32x4*)(cv + off);
        if (j >= DSEQ) { const size_t o2 = ((size_t)(db * WBUF + j - DSEQ) * 2 + gkv) * 64 + ch * 4; *(f32x4*)(a.out + OUT_KS + o2) = kv; *(f32x4*)(a.out + OUT_VS + o2) = vv; }
        u32x2 wk, wv; wk.x = pkh(kv[0], kv[1]); wk.y = pkh(kv[2], kv[3]); wv.x = pkh(vv[0], vv[1]); wv.y = pkh(vv[2], vv[3]);
        *(LAS u32x2*)(lds + OFF_K + j * KSTR + ch * 8) = wk; *(LAS u32x2*)(lds + OFF_V + j * KSTR + ch * 8) = wv; }
    if (tid < 32) { const int j = tid >> 3, ch = tid & 7; const size_t row = (size_t)MP + db * DSEQ + j;
        *(LAS u32x4*)(lds + OFF_K + (128 + j) * KSTR + ch * 16) = *(const u32x4*)(KH + row * 128 + gkv * 64 + ch * 8);
        *(LAS u32x4*)(lds + OFF_V + (128 + j) * KSTR + ch * 16) = *(const u32x4*)(VH + row * 128 + gkv * 64 + ch * 8); }
    else if (tid >= 64 && tid < 64 + 28 * 8) { const int e = tid - 64, j = 132 + (e >> 3), ch = e & 7; const u32x4 z = {0u, 0u, 0u, 0u};
        *(LAS u32x4*)(lds + OFF_K + j * KSTR + ch * 16) = z; *(LAS u32x4*)(lds + OFF_V + j * KSTR + ch * 16) = z; }
    for (int e = tid; e < 4 * 384; e += 512) ((LAS float*)(lds + OFF_TB))[e] = tbg[gkv * 4 * 384 + e];
    __syncthreads();
    if (wid == 0) {
        const int r = q >> 2, t = q & 3, h = 4 * gkv + r; const size_t row = (size_t)MP + db * DSEQ + t;
        const h8 q0 = *(const h8*)(MIX + row * DM + h * 64 + 8 * quad), q1 = *(const h8*)(MIX + row * DM + h * 64 + 32 + 8 * quad);
        const float sink = tbg[8 * 384 + h];
        const LAS float* tb = (const LAS float*)(lds + OFF_TB) + r * 384;
        f32x4 s[10]; float mx = sink;
#pragma unroll
        for (int i = 0; i < 10; ++i) { const LAS unsigned char* kp = lds + OFF_K + (16 * i + q) * KSTR + 16 * quad;
            const h8 k0 = *(const LAS h8*)kp, k1 = *(const LAS h8*)(kp + 64);
            f32x4 c = __builtin_amdgcn_mfma_f32_16x16x32_f16(k0, q0, (f32x4){0.f, 0.f, 0.f, 0.f}, 0, 0, 0); c = __builtin_amdgcn_mfma_f32_16x16x32_f16(k1, q1, c, 0, 0, 0);
            const int ib = 16 * i + 4 * quad - t - 1 + 128;
#pragma unroll
            for (int rr = 0; rr < 4; ++rr) { c[rr] += tb[ib + rr]; mx = fmaxf(mx, c[rr]); }
            s[i] = c; }
        mx = fmaxf(mx, __shfl_xor(mx, 16)); mx = fmaxf(mx, __shfl_xor(mx, 32));
        float ls = (quad == 0) ? ex2(sink - mx) : 0.f;
#pragma unroll
        for (int i = 0; i < 10; ++i)
#pragma unroll
            for (int rr = 0; rr < 4; ++rr) { const float p = ex2(s[i][rr] - mx); s[i][rr] = p; ls += p; }
        ls += __shfl_xor(ls, 16); ls += __shfl_xor(ls, 32);
        f32x4 o[4];
#pragma unroll
        for (int dt = 0; dt < 4; ++dt) o[dt] = (f32x4){0.f, 0.f, 0.f, 0.f};
#pragma unroll
        for (int pr = 0; pr < 5; ++pr) { u32x4 w; w.x = pkh(s[2 * pr][0], s[2 * pr][1]); w.y = pkh(s[2 * pr][2], s[2 * pr][3]); w.z = pkh(s[2 * pr + 1][0], s[2 * pr + 1][1]); w.w = pkh(s[2 * pr + 1][2], s[2 * pr + 1][3]);
            const h8 pf = __builtin_bit_cast(h8, w);
#pragma unroll
            for (int dt = 0; dt < 4; ++dt) o[dt] = __builtin_amdgcn_mfma_f32_16x16x32_f16(vt_frag(lds + OFF_V, 32 * pr, dt, lane), pf, o[dt], 0, 0, 0); }
        const float inv = 1.0f / ls; f16* op = MIX + row * DM + h * 64 + 4 * quad;
#pragma unroll
        for (int dt = 0; dt < 4; ++dt) { const f32x4 v = o[dt] * inv; u32x2 w; w.x = pkh(v[0], v[1]); w.y = pkh(v[2], v[3]); *(u32x2*)(op + 16 * dt) = w; }
    }
    __syncthreads();
}
}

namespace ssm {
constexpr int W2STR = 528, W3STR = 272;
constexpr int OFF_W2 = 0, OFF_W3 = 128 * W2STR, OFF_KG = OFF_W3 + 256 * W3STR, OFF_TOT = OFF_KG + 8192, END = OFF_TOT + 4096;
static_assert(END <= LDSCTL_OFF, "ssm LDS");
template <int S> __device__ __forceinline__ float row_shr(float v) { return __builtin_bit_cast(float, __builtin_amdgcn_update_dpp(0, __builtin_bit_cast(int, v), 0x110 + S, 0xf, 0xf, false)); }

__device__ __forceinline__ void stage_mats(const Frame& F, const Args& a, int g) {
    const unsigned char* blk = a.ws + WS_SSM + (size_t)g * SSM_STRIDE; LAS unsigned char* lds = F.lds;
#pragma unroll
    for (int it = 0; it < 8; ++it) { const int piece = it * 512 + F.tid; { const int row = piece >> 5, ch = piece & 31; *(LAS u32x4*)(lds + OFF_W2 + row * W2STR + ch * 16) = *(const u32x4*)(blk + SSM_W2 + (size_t)piece * 16); }
        { const int row = piece >> 4, ch = piece & 15; *(LAS u32x4*)(lds + OFF_W3 + row * W3STR + ch * 16) = *(const u32x4*)(blk + SSM_W3 + (size_t)piece * 16); } }
    *(LAS u32x4*)(lds + OFF_KG + F.tid * 16) = *(const u32x4*)(blk + SSM_KG + (size_t)F.tid * 16);
    __syncthreads();
}
__device__ __forceinline__ h8 kg_frag(const LAS unsigned char* lds, int dd, int lane) {
    const int d = dd < 0 ? 0 : dd; const h8 v = *(const LAS h8*)(lds + OFF_KG + (d * 16 + (lane & 15)) * 32 + ((lane >> 4) & 1) * 16);
    const h8 z = {0, 0, 0, 0, 0, 0, 0, 0}; return dd < 0 ? z : v;
}

__device__ __forceinline__ void prompt_item(const Frame& F, const Args& a, int b, int g) {
    const f16* UH = (const f16*)(a.ws + WS_UH); f16* YG = (f16*)(a.ws + WS_YG); const float* cst = (const float*)(a.ws + WS_SSM + (size_t)g * SSM_STRIDE + SSM_CONST);
    const float* dskip = a.in[21];
    LAS unsigned char* lds = F.lds; const int lane = F.lane, wid = F.wave, cj = lane & 15, quad = lane >> 4;
    const float dt = cst[256];
    const size_t tokc = (size_t)b * SEQ + (size_t)(16 * wid + cj) * 16;
    h8 U[8];
#pragma unroll
    for (int ks = 0; ks < 8; ++ks) U[ks] = *(const h8*)(UH + (tokc + 2 * ks + (quad >> 1)) * 512 + g * 16 + (quad & 1) * 8);
    f32x4 xa[8];
#pragma unroll
    for (int kt = 0; kt < 8; ++kt) { f32x4 c = {0.f, 0.f, 0.f, 0.f};
#pragma unroll
        for (int ks = 0; ks < 8; ++ks) c = __builtin_amdgcn_mfma_f32_16x16x32_f16(*(const LAS h8*)(lds + OFF_W2 + (16 * kt + cj) * W2STR + (32 * ks + 8 * quad) * 2), U[ks], c, 0, 0, 0);
        xa[kt] = c; }
    LAS float* tot = (LAS float*)(lds + OFF_TOT);
    const float* P16r = cst + 320; const float* P16i = cst + 320 + 17 * 64;
    f32x4 xr[4], xi[4];
#pragma unroll
    for (int kt = 0; kt < 4; ++kt) { const f32x4 l16r = *(const f32x4*)(P16r + 64 + 16 * kt + 4 * quad), l16i = *(const f32x4*)(P16i + 64 + 16 * kt + 4 * quad);
#pragma unroll
        for (int rg = 0; rg < 4; ++rg) { float x_r = xa[kt][rg], x_i = xa[kt + 4][rg], c_r = l16r[rg], c_i = l16i[rg];
#define SSM_STEP(S) { const float y_r = row_shr<S>(x_r), y_i = row_shr<S>(x_i); x_r += c_r * y_r - c_i * y_i; x_i += c_r * y_i + c_i * y_r; \
            { const float t_ = c_r * c_r - c_i * c_i; c_i = 2.f * c_r * c_i; c_r = t_; } }
            SSM_STEP(1) SSM_STEP(2) SSM_STEP(4) SSM_STEP(8)
#undef SSM_STEP
            xr[kt][rg] = x_r; xi[kt][rg] = x_i;
            if (cj == 15) { const int p = 16 * kt + 4 * quad + rg; tot[(wid * 64 + p) * 2] = x_r; tot[(wid * 64 + p) * 2 + 1] = x_i; } } }
    __syncthreads();
    h8 Xf[4];
    {
        u32x4 xw[4];
#pragma unroll
        for (int kt = 0; kt < 4; ++kt) { float sr[4], si[4];
            const f32x4 Lr = *(const f32x4*)(P16r + 16 * 64 + 16 * kt + 4 * quad), Li = *(const f32x4*)(P16i + 16 * 64 + 16 * kt + 4 * quad);
            const f32x4 Pr = *(const f32x4*)(P16r + cj * 64 + 16 * kt + 4 * quad), Pi = *(const f32x4*)(P16i + cj * 64 + 16 * kt + 4 * quad);
#pragma unroll
            for (int rg = 0; rg < 4; ++rg) { const int p = 16 * kt + 4 * quad + rg; float C_r = 0.f, C_i = 0.f;
                for (int m = 0; m < wid; ++m) { const float t_r = tot[(m * 64 + p) * 2], t_i = tot[(m * 64 + p) * 2 + 1];
                    const float n_r = Lr[rg] * C_r - Li[rg] * C_i + t_r; C_i = Lr[rg] * C_i + Li[rg] * C_r + t_i; C_r = n_r; }
                const float e_r = row_shr<1>(xr[kt][rg]), e_i = row_shr<1>(xi[kt][rg]);
                sr[rg] = e_r + Pr[rg] * C_r - Pi[rg] * C_i; si[rg] = e_i + Pr[rg] * C_i + Pi[rg] * C_r;
                if (wid == 7 && cj == 15) { const float f_r = xr[kt][rg] + Lr[rg] * C_r - Li[rg] * C_i, f_i = xi[kt][rg] + Lr[rg] * C_i + Li[rg] * C_r;
                    a.out[OUT_SRP + (size_t)(b * NG + g) * 64 + p] = dt * f_r; a.out[OUT_SIP + (size_t)(b * NG + g) * 64 + p] = dt * f_i; } }
            const unsigned r01 = pkh(sr[0], sr[1]), r23 = pkh(sr[2], sr[3]), i01 = pkh(si[0], si[1]), i23 = pkh(si[2], si[3]);
            if (kt & 1) { xw[kt >> 1].z = r01; xw[kt >> 1].w = r23; xw[2 + (kt >> 1)].z = i01; xw[2 + (kt >> 1)].w = i23; }
            else        { xw[kt >> 1].x = r01; xw[kt >> 1].y = r23; xw[2 + (kt >> 1)].x = i01; xw[2 + (kt >> 1)].y = i23; } }
#pragma unroll
        for (int k4 = 0; k4 < 4; ++k4) Xf[k4] = __builtin_bit_cast(h8, xw[k4]);
    }
    const f32x4 dsk = *(const f32x4*)(dskip + g * 16 + 4 * quad);
#pragma unroll 1
    for (int t = 0; t < 16; ++t) { f32x4 c = {0.f, 0.f, 0.f, 0.f};
#pragma unroll
        for (int ks = 0; ks < 8; ++ks) if (2 * ks <= t) c = __builtin_amdgcn_mfma_f32_16x16x32_f16(kg_frag(lds, t - 2 * ks - (quad >> 1), lane), U[ks], c, 0, 0, 0);
#pragma unroll
        for (int k4 = 0; k4 < 4; ++k4) c = __builtin_amdgcn_mfma_f32_16x16x32_f16(*(const LAS h8*)(lds + OFF_W3 + (16 * t + cj) * W3STR + (32 * k4 + 8 * quad) * 2), Xf[k4], c, 0, 0, 0);
        const size_t tok = tokc + t; const h4 u4 = *(const h4*)(UH + tok * 512 + g * 16 + 4 * quad);
        const float y0 = gelu_tanh(dt * c[0] + dsk[0] * (float)u4[0]), y1 = gelu_tanh(dt * c[1] + dsk[1] * (float)u4[1]), y2 = gelu_tanh(dt * c[2] + dsk[2] * (float)u4[2]), y3 = gelu_tanh(dt * c[3] + dsk[3] * (float)u4[3]);
        u32x2 w; w.x = pkh(y0, y1); w.y = pkh(y2, y3); *(u32x2*)(YG + tok * 512 + g * 16 + 4 * quad) = w; }
}

__device__ __forceinline__ void sample_unit(const Frame& F, const Args& a, int g, int db0) {
    const f16* UH = (const f16*)(a.ws + WS_UH); f16* YG = (f16*)(a.ws + WS_YG); const float* cst = (const float*)(a.ws + WS_SSM + (size_t)g * SSM_STRIDE + SSM_CONST);
    const float* dskip = a.in[21]; const float* st_re = a.in[4]; const float* st_im = a.in[5];
    LAS unsigned char* lds = F.lds; const int lane = F.lane, cj = lane & 15, quad = lane >> 4, db = db0 + cj;
    const float dt = cst[256], rdt = 1.0f / dt;
    const size_t tokc = (size_t)MP + (size_t)db * DSEQ;
    h8 U[2];
#pragma unroll
    for (int ks = 0; ks < 2; ++ks) U[ks] = *(const h8*)(UH + (tokc + 2 * ks + (quad >> 1)) * 512 + g * 16 + (quad & 1) * 8);
    f32x4 x0r[4], x0i[4];
#pragma unroll
    for (int kt = 0; kt < 4; ++kt) { x0r[kt] = *(const f32x4*)(st_re + ((size_t)db * NG + g) * 64 + 16 * kt + 4 * quad); x0i[kt] = *(const f32x4*)(st_im + ((size_t)db * NG + g) * 64 + 16 * kt + 4 * quad); }
#pragma unroll
    for (int kt = 0; kt < 4; ++kt) { f32x4 cr_ = {0.f, 0.f, 0.f, 0.f}, ci_ = {0.f, 0.f, 0.f, 0.f};
#pragma unroll
        for (int ks = 0; ks < 2; ++ks) { cr_ = __builtin_amdgcn_mfma_f32_16x16x32_f16(*(const LAS h8*)(lds + OFF_W2 + (16 * kt + cj) * W2STR + (32 * (6 + ks) + 8 * quad) * 2), U[ks], cr_, 0, 0, 0);
            ci_ = __builtin_amdgcn_mfma_f32_16x16x32_f16(*(const LAS h8*)(lds + OFF_W2 + (64 + 16 * kt + cj) * W2STR + (32 * (6 + ks) + 8 * quad) * 2), U[ks], ci_, 0, 0, 0); }
        const f32x4 l4r = *(const f32x4*)(cst + 128 + 16 * kt + 4 * quad), l4i = *(const f32x4*)(cst + 192 + 16 * kt + 4 * quad);
        const f32x4 er = l4r * x0r[kt] - l4i * x0i[kt] + cr_ * dt, ei = l4r * x0i[kt] + l4i * x0r[kt] + ci_ * dt;
        *(f32x4*)(a.out + OUT_SRS + ((size_t)db * NG + g) * 64 + 16 * kt + 4 * quad) = er; *(f32x4*)(a.out + OUT_SIS + ((size_t)db * NG + g) * 64 + 16 * kt + 4 * quad) = ei; }
    h8 Xf[4];
#pragma unroll
    for (int k4 = 0; k4 < 2; ++k4) { u32x4 wr_, wi_; const f32x4 a0 = x0r[2 * k4] * rdt, a1 = x0r[2 * k4 + 1] * rdt, b0 = x0i[2 * k4] * rdt, b1 = x0i[2 * k4 + 1] * rdt;
        wr_.x = pkh(a0[0], a0[1]); wr_.y = pkh(a0[2], a0[3]); wr_.z = pkh(a1[0], a1[1]); wr_.w = pkh(a1[2], a1[3]);
        wi_.x = pkh(b0[0], b0[1]); wi_.y = pkh(b0[2], b0[3]); wi_.z = pkh(b1[0], b1[1]); wi_.w = pkh(b1[2], b1[3]);
        Xf[k4] = __builtin_bit_cast(h8, wr_); Xf[2 + k4] = __builtin_bit_cast(h8, wi_); }
    const f32x4 dsk = *(const f32x4*)(dskip + g * 16 + 4 * quad);
#pragma unroll
    for (int t = 0; t < 4; ++t) { f32x4 c = {0.f, 0.f, 0.f, 0.f};
#pragma unroll
        for (int ks = 0; ks < 2; ++ks) if (2 * ks <= t) c = __builtin_amdgcn_mfma_f32_16x16x32_f16(kg_frag(lds, t - 2 * ks - (quad >> 1), lane), U[ks], c, 0, 0, 0);
#pragma unroll
        for (int k4 = 0; k4 < 4; ++k4) c = __builtin_amdgcn_mfma_f32_16x16x32_f16(*(const LAS h8*)(lds + OFF_W3 + (16 * t + cj) * W3STR + (32 * k4 + 8 * quad) * 2), Xf[k4], c, 0, 0, 0);
        const size_t tok = tokc + t; const h4 u4 = *(const h4*)(UH + tok * 512 + g * 16 + 4 * quad);
        const float y0 = gelu_tanh(dt * c[0] + dsk[0] * (float)u4[0]), y1 = gelu_tanh(dt * c[1] + dsk[1] * (float)u4[1]), y2 = gelu_tanh(dt * c[2] + dsk[2] * (float)u4[2]), y3 = gelu_tanh(dt * c[3] + dsk[3] * (float)u4[3]);
        u32x2 w; w.x = pkh(y0, y1); w.y = pkh(y2, y3); *(u32x2*)(YG + tok * 512 + g * 16 + 4 * quad) = w; }
}
}

__global__ void __launch_bounds__(NWAVES * 64, 2) hymba_fwd(Args args) {
    extern __shared__ __attribute__((aligned(16))) unsigned char lds_raw[];
    Frame F;
    F.lds = (LAS unsigned char*)lds_raw;
    F.MISC = (volatile LAS unsigned*)(F.lds + MISC_OFF);
    F.tid = threadIdx.x; F.lane = F.tid & 63; F.wave = __builtin_amdgcn_readfirstlane(F.tid >> 6);
    F.G = gridDim.x; { const int bx = blockIdx.x; F.vcu = (F.G % 8 == 0) ? (bx % 8) * (F.G / 8) + bx / 8 : bx; }
    unsigned char* ws = args.ws;
    F.ctl = (unsigned*)(ws + WS_CTL);
    for (int u = F.tid; u < (LDS_BYTES - LDSCTL_OFF) / 4; u += NWAVES * 64) ((LAS unsigned*)(F.lds + LDSCTL_OFF))[u] = 0u;
    __syncthreads();
    XcdBarrier bar = xcd_barrier_post(F.ctl + CW_BAR, F.MISC + 8);
    const int lo = args.ph_lo, hi = args.ph_hi;
#define IN(k) (lo <= (k) && (k) < hi)
#define SEAM(k) do { if (IN(k) && IN((k) + 1)) xcd_barrier(bar); } while (0)

    f16* XH = (f16*)(ws + WS_XH); float* XR = (float*)(ws + WS_XR); f16* ACT = (f16*)(ws + WS_ACT); f16* MIX = (f16*)(ws + WS_MIX);
    f16* KH = (f16*)(ws + WS_KH); f16* VH = (f16*)(ws + WS_VH); f16* UH = (f16*)(ws + WS_UH); f16* YG = (f16*)(ws + WS_YG);
    float* SSQ1 = (float*)(ws + WS_SSQ1); float* SSQ2 = (float*)(ws + WS_SSQ2); float* SSQ3 = (float*)(ws + WS_SSQ3);

    if (IN(0)) { p0_prologue(F, args); }
    SEAM(0);
    if (IN(1)) {
        pg8::Gemm g{XH, (const f16*)(ws + WS_W1A), M, 2 * DFF, DM}; pg8::StaticOrder S; S.init(M, 2 * DFF, F.G, (int)blockIdx.x);
        pg8::EpiSwiGLU E{ACT, SSQ1};
        pg8::gemm_phase<pg8::EpiSwiGLU, pg8::StaticOrder, true, true>(F.lds, g, S, E);
    }
    SEAM(1);
    if (IN(2)) {
        pg8::Gemm g{ACT, (const f16*)(ws + WS_W1D), M, DM, DFF}; pg8::StaticOrder S; S.init(M, DM, F.G, (int)blockIdx.x);
        pg8::EpiResid E{args.in[0], args.in[1], XR, XH, SSQ2, 0.5f};
        pg8::gemm_phase<pg8::EpiResid, pg8::StaticOrder, true, true>(F.lds, g, S, E);
    }
    SEAM(2);
    if (IN(3)) {
        pg8::Gemm g{XH, (const f16*)(ws + WS_WIN), M, DIN, DM}; pg8::StaticOrder S; S.init(M, DIN, F.G, (int)blockIdx.x);
        pg8::EpiWin E{MIX, KH, VH, UH, SSQ2, args.out};
        pg8::gemm_phase<pg8::EpiWin, pg8::StaticOrder, true, true>(F.lds, g, S, E);
    }
    SEAM(3);
    if (IN(4)) {
        const int v = F.vcu;
        if (v < 256) {
            const int g = v >> 3;
            ssm::stage_mats(F, args, g);
            ssm::prompt_item(F, args, v & 7, g);
            if (F.wave == 0) ssm::sample_unit(F, args, g, (v & 7) * 16);
            __syncthreads();
            att::prompt_unit(F, args, v >> 5, (v >> 1) & 15, v & 1);
            att::sample_unit(F, args, v >> 1, v & 1);
        }
    }
    SEAM(4);
    if (IN(5)) {
        pg8::Gemm g{YG, (const f16*)(ws + WS_WGLU), M, 512, 512}; pg8::StaticOrder S; S.init(M, 512, F.G, (int)blockIdx.x);
        pg8::EpiGlu E{YG, MIX, args.in[23]};
        pg8::gemm_phase<pg8::EpiGlu, pg8::StaticOrder, true, true>(F.lds, g, S, E);
    }
    SEAM(5);
    if (IN(6)) {
        pg8::Gemm g{MIX, (const f16*)(ws + WS_WOUT), M, DM, DM}; pg8::StaticOrder S; S.init(M, DM, F.G, (int)blockIdx.x);
        pg8::EpiResid E{XR, XR + (size_t)MP * DM, XR, XH, SSQ3, 1.0f};
        pg8::gemm_phase<pg8::EpiResid, pg8::StaticOrder, true, true>(F.lds, g, S, E);
    }
    SEAM(6);
    if (IN(7)) {
        pg8::Gemm g{XH, (const f16*)(ws + WS_W2A), M, 2 * DFF, DM}; pg8::StaticOrder S; S.init(M, 2 * DFF, F.G, (int)blockIdx.x);
        pg8::EpiSwiGLU E{ACT, SSQ3};
        pg8::gemm_phase<pg8::EpiSwiGLU, pg8::StaticOrder, true, true>(F.lds, g, S, E);
    }
    SEAM(7);
    if (IN(8)) {
        pg8::Gemm g{ACT, (const f16*)(ws + WS_W2D), M, DM, DFF}; pg8::StaticOrder S; S.init(M, DM, F.G, (int)blockIdx.x);
        pg8::EpiResid E{XR, XR + (size_t)MP * DM, args.out, nullptr, nullptr, 0.5f};
        pg8::gemm_phase<pg8::EpiResid, pg8::StaticOrder, true, true>(F.lds, g, S, E);
    }
    SEAM(8);
    if (IN(9)) {
        const float* fn = args.in[29]; const int gw = F.vcu * NWAVES + F.wave, NGW = F.G * NWAVES;
        f32x4 gn[4];
#pragma unroll
        for (int j = 0; j < 4; ++j) gn[j] = ((const f32x4*)fn)[F.lane + 64 * j];
        for (int m = gw; m < M; m += NGW) {
            f32x4* xr = (f32x4*)(args.out + (size_t)m * DM) + F.lane; f32x4 v[4]; float s = 0.f;
#pragma unroll
            for (int j = 0; j < 4; ++j) { v[j] = xr[64 * j]; s += (v[j].x * v[j].x + v[j].y * v[j].y) + (v[j].z * v[j].z + v[j].w * v[j].w); }
            s = wave_sum(s); const float r = 1.0f / sqrtf(s * (1.0f / 1024.0f) + RMS_EPS);
#pragma unroll
            for (int j = 0; j < 4; ++j) xr[64 * j] = (v[j] * r) * gn[j];
        }
    }
#undef IN
#undef SEAM
}

extern "C" void kernel_launch(void* const* d_in, const int* in_sizes, int n_in, void* d_out, int out_size, void* d_ws, size_t ws_size, hipStream_t stream) {
    static int grid = 0;
    if (grid == 0) {
        if (n_in != 30 || (size_t)out_size != OUT_END || ws_size < WS_END) { fprintf(stderr, "kernel_launch: unexpected sizes n_in %d out %d ws %zu\n", n_in, out_size, ws_size); grid = -1; return; }
        int dev = 0, cus = 0;
        if (hipGetDevice(&dev) != hipSuccess || hipDeviceGetAttribute(&cus, hipDeviceAttributeMultiprocessorCount, dev) != hipSuccess) { grid = -1; return; }
        if (hipFuncSetAttribute((const void*)hymba_fwd, hipFuncAttributeMaxDynamicSharedMemorySize, LDS_BYTES) != hipSuccess) { fprintf(stderr, "kernel_launch: hipFuncSetAttribute failed\n"); grid = -1; return; }
        int per_cu = 0;
        if (hipOccupancyMaxActiveBlocksPerMultiprocessor(&per_cu, (const void*)hymba_fwd, NWAVES * 64, LDS_BYTES) != hipSuccess || per_cu < 1) { fprintf(stderr, "kernel_launch: occupancy query says %d\n", per_cu); }
        (void)hipGetLastError();
        grid = cus;
    }
    if (grid < 0) return;
    (void)hipMemsetAsync((char*)d_ws + WS_CTL, 0, CTL_ZERO_BYTES, stream);
    Args a{};
    for (int i = 0; i < 30; ++i) a.in[i] = (const float*)d_in[i];
    a.out = (float*)d_out; a.ws = (unsigned char*)d_ws; a.ph_lo = 0; a.ph_hi = 10;
    hipLaunchKernelGGL(hymba_fwd, dim3(grid), dim3(NWAVES * 64), LDS_BYTES, stream, a);
}
```
